# Optimizing an MI355X kernel written in HIP

```python
import math
import jax, jax.numpy as jnp
from jax import lax
import numpy as np

D_MODEL = 1024
BATCH = 8
SEQ = 2048
DEPTH = 4

HEAD_DIM = 64
ATT_HEADS = D_MODEL // HEAD_DIM
ATT_WIDTH = ATT_HEADS * HEAD_DIM
ROT_DIM = HEAD_DIM // 4
ROPE_THETA = 500000.0
DILATED_PATTERNS = ((128, 1), (512, 4), (2048, 16))
MAX_REACH = 2048
Q_BLOCK = 128
SSM_WIDTH = D_MODEL // 2
SSM_GROUP = 16
SSM_GROUPS = SSM_WIDTH // SSM_GROUP
SSM_STATE = 64
POOL_WIDTH = 2 * D_MODEL
POOL_WINDOWS = (2, 4, 8, 16)
POOL_GROUP = POOL_WIDTH // len(POOL_WINDOWS)
EVEN_IN = 4 * ATT_WIDTH + 2 * SSM_WIDTH
EVEN_OUT = ATT_WIDTH + SSM_WIDTH
ODD_IN = 2 * POOL_WIDTH
N_EVEN = (DEPTH + 1) // 2
N_ODD = DEPTH // 2
RMS_EPS = 1e-6

kernel_name = "hybrid_dilated_attn_s5_pool_block"


def rmsnorm(x, gain):
    xf = x.astype(jnp.float32)
    y = xf * lax.rsqrt(jnp.mean(xf * xf, axis=-1, keepdims=True) + RMS_EPS)
    return (y * gain.astype(jnp.float32)).astype(x.dtype)


def apply_partial_rope(x, pos):
    half = ROT_DIM // 2
    inv_freq = ROPE_THETA ** (-jnp.arange(0, ROT_DIM, 2, dtype=jnp.float32) / ROT_DIM)
    ang = pos.astype(jnp.float32)[:, None] * inv_freq[None, :]
    cos = jnp.cos(ang)[None, :, None, :]
    sin = jnp.sin(ang)[None, :, None, :]
    xr = x[..., :ROT_DIM].astype(jnp.float32)
    x1, x2 = xr[..., :half], xr[..., half:]
    rot = jnp.concatenate([x1 * cos - x2 * sin, x2 * cos + x1 * sin], axis=-1)
    return jnp.concatenate([rot.astype(x.dtype), x[..., ROT_DIM:]], axis=-1)


def dilated_offsets():
    return np.concatenate([np.arange(w // d + 1) * d for w, d in DILATED_PATTERNS]).astype(np.int32)


def dilated_attention(q, k, v):
    b, s, h, dh = q.shape
    offsets = jnp.asarray(dilated_offsets())
    qh = q.transpose(0, 2, 1, 3)
    pad = ((0, 0), (0, 0), (MAX_REACH, 0), (0, 0))
    k_pad = jnp.pad(k.transpose(0, 2, 1, 3), pad)
    v_pad = jnp.pad(v.transpose(0, 2, 1, 3), pad)

    def block(bi):
        start = bi * Q_BLOCK
        q_blk = lax.dynamic_slice_in_dim(qh, start, Q_BLOCK, axis=2)
        rel = start + jnp.arange(Q_BLOCK, dtype=jnp.int32)[:, None] - offsets[None, :]
        k_g = k_pad[:, :, rel + MAX_REACH]
        v_g = v_pad[:, :, rel + MAX_REACH]
        scores = jnp.einsum('bhqd,bhqkd->bhqk', q_blk, k_g).astype(jnp.float32)
        scores = jnp.where(rel >= 0, scores, -jnp.inf)
        p = jax.nn.softmax(scores, axis=-1)
        return jnp.einsum('bhqk,bhqkd->bhqd', p.astype(v.dtype), v_g)

    out = lax.map(block, jnp.arange(s // Q_BLOCK, dtype=jnp.int32))
    return out.transpose(1, 0, 3, 2, 4).reshape(b, s, h * dh)


def s5_ssm(u, a_re, a_im, log_dt, b_re, b_im, c_re, c_im, d_skip, glu_w, glu_b):
    bsz, s, _ = u.shape
    f32 = jnp.float32
    uf = u.astype(f32)
    ug = uf.reshape(bsz, s, SSM_GROUPS, SSM_GROUP)
    lam = lax.complex(a_re.astype(f32), a_im.astype(f32))
    dt = jnp.exp(log_dt.astype(f32))[:, None]
    lam_bar = jnp.exp(lam * dt)
    b_mat = lax.complex(b_re.astype(f32), b_im.astype(f32))
    b_bar = ((lam_bar - 1.0) / lam)[..., None] * b_mat
    bu = jnp.einsum('bsgh,gph->bsgp', ug.astype(jnp.complex64), b_bar)
    a_seq = jnp.broadcast_to(lam_bar, bu.shape)

    def combine(left, right):
        a_l, s_l = left
        a_r, s_r = right
        return a_r * a_l, a_r * s_l + s_r

    _, states = lax.associative_scan(combine, (a_seq, bu), axis=1)
    c_mat = lax.complex(c_re.astype(f32), c_im.astype(f32))
    y = jnp.real(jnp.einsum('bsgp,ghp->bsgh', states, c_mat)).reshape(bsz, s, SSM_WIDTH)
    y = jax.nn.gelu(y + d_skip.astype(f32) * uf)
    y = y * jax.nn.sigmoid(y @ glu_w.astype(f32) + glu_b.astype(f32))
    return y.astype(u.dtype)


def multiscale_pool(u, pool_w, pool_scale):
    bsz, s, _ = u.shape
    ug = u.astype(jnp.float32).reshape(bsz, s, len(POOL_WINDOWS), POOL_GROUP)
    count_base = jnp.arange(1, s + 1, dtype=jnp.float32)[None, :, None]
    outs = []
    for g, w in enumerate(POOL_WINDOWS):
        ch = ug[:, :, g]
        cs = jnp.cumsum(ch, axis=1)
        lagged = jnp.pad(cs, ((0, 0), (w, 0), (0, 0)))[:, :s]
        mean = (cs - lagged) / jnp.minimum(count_base, float(w))
        outs.append(mean - ch)
    mixed = jnp.stack(outs, axis=2)
    y = jnp.einsum('bsgc,gcd->bsgd', mixed, pool_w.astype(jnp.float32)).reshape(bsz, s, POOL_WIDTH)
    return (y * pool_scale.astype(jnp.float32)).astype(u.dtype)


def even_mixer(h, w_in, w_out, a_re, a_im, log_dt, b_re, b_im, c_re, c_im, d_skip, glu_w, glu_b):
    bsz, s, _ = h.shape
    proj = h @ w_in
    cuts = [ATT_WIDTH, 2 * ATT_WIDTH, 3 * ATT_WIDTH, 4 * ATT_WIDTH, 4 * ATT_WIDTH + SSM_WIDTH]
    q, k, v, g_att, u_ssm, g_ssm = jnp.split(proj, cuts, axis=-1)
    pos = jnp.arange(s, dtype=jnp.int32)
    q = apply_partial_rope(q.reshape(bsz, s, ATT_HEADS, HEAD_DIM), pos) * (HEAD_DIM ** -0.5)
    k = apply_partial_rope(k.reshape(bsz, s, ATT_HEADS, HEAD_DIM), pos)
    v = v.reshape(bsz, s, ATT_HEADS, HEAD_DIM)
    att = dilated_attention(q, k, v)
    ssm = s5_ssm(u_ssm, a_re, a_im, log_dt, b_re, b_im, c_re, c_im, d_skip, glu_w, glu_b)
    merged = jnp.concatenate([att * jax.nn.silu(g_att), ssm * jax.nn.silu(g_ssm)], axis=-1)
    return merged @ w_out


def odd_mixer(h, w_in, pool_w, pool_scale, w_out):
    u, gate = jnp.split(h @ w_in, [POOL_WIDTH], axis=-1)
    y = multiscale_pool(u, pool_w, pool_scale)
    return (y * jax.nn.silu(gate)) @ w_out


def setup_inputs(seed: int = 0) -> dict:
    key = jax.random.key(seed)
    ks = jax.random.split(key, 24)
    f32 = jnp.float32

    def nrm(k, shape, scale):
        return jax.random.normal(k, shape, f32) * scale

    n_idx = jnp.arange(SSM_STATE, dtype=f32)
    return {
        "x": jax.random.normal(ks[0], (BATCH, SEQ, D_MODEL), f32),
        "pre_norm": 1.0 + nrm(ks[1], (DEPTH, D_MODEL), 0.1),
        "post_norm": 1.0 + nrm(ks[2], (DEPTH, D_MODEL), 0.1),
        "even_w_in": nrm(ks[3], (N_EVEN, D_MODEL, EVEN_IN), D_MODEL ** -0.5),
        "even_w_out": nrm(ks[4], (N_EVEN, EVEN_OUT, D_MODEL), EVEN_OUT ** -0.5),
        "ssm_a_re": -0.5 + nrm(ks[5], (N_EVEN, SSM_GROUPS, SSM_STATE), 0.01),
        "ssm_a_im": math.pi * n_idx + nrm(ks[6], (N_EVEN, SSM_GROUPS, SSM_STATE), 0.01),
        "ssm_log_dt": jax.random.uniform(ks[7], (N_EVEN, SSM_GROUPS), f32, math.log(1e-3), math.log(1e-1)),
        "ssm_b_re": nrm(ks[8], (N_EVEN, SSM_GROUPS, SSM_STATE, SSM_GROUP), (2 * SSM_GROUP) ** -0.5),
        "ssm_b_im": nrm(ks[9], (N_EVEN, SSM_GROUPS, SSM_STATE, SSM_GROUP), (2 * SSM_GROUP) ** -0.5),
        "ssm_c_re": nrm(ks[10], (N_EVEN, SSM_GROUPS, SSM_GROUP, SSM_STATE), (2 * SSM_STATE) ** -0.5),
        "ssm_c_im": nrm(ks[11], (N_EVEN, SSM_GROUPS, SSM_GROUP, SSM_STATE), (2 * SSM_STATE) ** -0.5),
        "ssm_d": nrm(ks[12], (N_EVEN, SSM_WIDTH), 1.0),
        "ssm_glu_w": nrm(ks[13], (N_EVEN, SSM_WIDTH, SSM_WIDTH), SSM_WIDTH ** -0.5),
        "ssm_glu_b": nrm(ks[14], (N_EVEN, SSM_WIDTH), 0.02),
        "odd_w_in": nrm(ks[15], (N_ODD, D_MODEL, ODD_IN), D_MODEL ** -0.5),
        "pool_w": nrm(ks[16], (N_ODD, len(POOL_WINDOWS), POOL_GROUP, POOL_GROUP), POOL_GROUP ** -0.5),
        "pool_scale": 1.0 + nrm(ks[17], (N_ODD, POOL_WIDTH), 0.1),
        "odd_w_out": nrm(ks[18], (N_ODD, POOL_WIDTH, D_MODEL), POOL_WIDTH ** -0.5),
    }


def reference(x, pre_norm, post_norm, even_w_in, even_w_out, ssm_a_re, ssm_a_im, ssm_log_dt,
              ssm_b_re, ssm_b_im, ssm_c_re, ssm_c_im, ssm_d, ssm_glu_w, ssm_glu_b,
              odd_w_in, pool_w, pool_scale, odd_w_out):
    for layer in range(DEPTH):
        h = rmsnorm(x, pre_norm[layer])
        i = layer // 2
        if layer % 2 == 0:
            y = even_mixer(h, even_w_in[i], even_w_out[i], ssm_a_re[i], ssm_a_im[i], ssm_log_dt[i],
                           ssm_b_re[i], ssm_b_im[i], ssm_c_re[i], ssm_c_im[i], ssm_d[i],
                           ssm_glu_w[i], ssm_glu_b[i])
        else:
            y = odd_mixer(h, odd_w_in[i], pool_w[i], pool_scale[i], odd_w_out[i])
        x = x + rmsnorm(y, post_norm[layer])
    return x
```

```cpp
#include <hip/hip_runtime.h>
#include <cstdio>
#include <cstdint>

#ifndef MK_ONE_LAUNCH
#define MK_ONE_LAUNCH 0
#endif

#define LAS __attribute__((address_space(3)))
#define GAS __attribute__((address_space(1)))
typedef unsigned short bf16_t;
typedef short bf16x8 __attribute__((ext_vector_type(8)));
typedef short s16x4 __attribute__((ext_vector_type(4)));
typedef float f32x4 __attribute__((ext_vector_type(4)));
typedef float f32x2 __attribute__((ext_vector_type(2)));
typedef float f32x16 __attribute__((ext_vector_type(16)));
typedef unsigned u32x4 __attribute__((ext_vector_type(4)));
typedef unsigned u32x2 __attribute__((ext_vector_type(2)));

constexpr int D_MODEL = 1024, BATCH = 8, SEQ = 2048, DEPTH = 4;
constexpr int M_TOK = BATCH * SEQ;
constexpr int EVEN_IN = 5120, EVEN_OUT = 1536, ODD_IN = 4096, POOL_W = 2048, SSM_W = 512;
constexpr float RMS_EPS = 1e-6f;
constexpr float LOG2E = 1.4426950408889634f;
constexpr float QSCALE = 0.125f * LOG2E;

__device__ __forceinline__ unsigned f2bf(float f) { unsigned u = __builtin_bit_cast(unsigned, f); return (u + 0x7fffu + ((u >> 16) & 1u)) >> 16; }
__device__ __forceinline__ unsigned pk2(float lo, float hi) { return f2bf(lo) | (f2bf(hi) << 16); }
__device__ __forceinline__ float bf2f(unsigned short b) { return __builtin_bit_cast(float, (unsigned)b << 16); }
__device__ __forceinline__ float bflo(unsigned w) { return __builtin_bit_cast(float, w << 16); }
__device__ __forceinline__ float bfhi(unsigned w) { return __builtin_bit_cast(float, w & 0xffff0000u); }
__device__ __forceinline__ float sigmoidf_(float v) { return __builtin_amdgcn_rcpf(1.0f + __builtin_amdgcn_exp2f(-v * LOG2E)); }
__device__ __forceinline__ float siluf_(float v) { return v * sigmoidf_(v); }
__device__ __forceinline__ float gelu_tanh(float y) { const float t = 0.7978845608028654f * (y + 0.044715f * y * y * y); return y * sigmoidf_(2.0f * t); }
__device__ __forceinline__ float wave_sum(float v) {
#pragma unroll
    for (int o = 1; o < 64; o <<= 1) v += __shfl_xor(v, o);
    return v;
}
__device__ __forceinline__ float swap_half(float v) {
    auto rr = __builtin_amdgcn_permlane32_swap(__float_as_uint(v), __float_as_uint(v), false, false);
    return (threadIdx.x & 32) ? __uint_as_float(rr[0]) : __uint_as_float(rr[1]);
}

namespace pg8 {
constexpr int BM = 256, BK = 64, HALF = 128, HTB = HALF * BK * 2, STAGE_BYTES = 8 * HTB, NXCD = 8, WGM = 8;
__host__ __device__ __forceinline__ int lds_byte(int r, int c) { const int st = (r >> 4) * 2 + (c >> 5), rr = r & 15, cc = c & 31, ob = rr * 64 + cc * 2; return st * 1024 + (ob ^ (((ob >> 9) & 1) << 5)); }
__host__ __device__ __forceinline__ void stage_rc(int b, int& R, int& C) { const int st = b / 1024, sb = b % 1024, swz = sb ^ (((sb >> 9) & 1) << 5); R = (st >> 1) * 16 + swz / 64; C = (st & 1) * 32 + (swz % 64) / 2; }
__host__ __device__ __forceinline__ int perm32(int rho) { const int n = rho >> 4, i = rho & 15; return 8 * (i >> 2) + 4 * n + (i & 3); }

struct Unit { int pm, pn; };
struct Gemm { const bf16_t* A; const bf16_t* Bt; int M, N, K, lda, a_grp, a_grp_cols; };

struct StaticOrder {
    int nM, nN, nwg, G, c;
    __host__ __device__ void init(int M, int N, int G_, int c_) { nM = M / BM; nN = N / BM; nwg = nM * nN; G = G_; c = c_; }
    __host__ __device__ bool next(int i, Unit& u) const {
        const long L = (long)i * G + c; if (L >= nwg) return false;
        int wgid = (int)L; { const int q = nwg / NXCD, r = nwg % NXCD, xcd = wgid % NXCD, off = wgid / NXCD; wgid = (xcd < r ? xcd * (q + 1) : r * (q + 1) + (xcd - r) * q) + off; }
        const int nig = WGM * nN, gid = wgid / nig, fm = gid * WGM, gsz = (nM - fm) < WGM ? (nM - fm) : WGM;
        u.pm = fm + ((wgid % nig) % gsz); u.pn = (wgid % nig) / gsz; return true;
    }
};

template <class Epi, bool ALIGN_EPI = true>
__device__ __forceinline__ void gemm_phase(LAS unsigned char* lds, const Gemm g, const StaticOrder& S, const Epi& E, const int tid) {
    const int wid = __builtin_amdgcn_readfirstlane(tid >> 6), lane = tid & 63, wr = wid >> 2, wc = wid & 3, fr = lane & 15, fq = lane >> 4;
    const int K = g.K, nt = K / BK, lda = g.lda;
    unsigned voffA[2], voffB[2];
#pragma unroll
    for (int i = 0; i < 2; ++i) { int R, C; stage_rc(tid * 16 + i * 8192, R, C); const int Rb = Epi::PERM ? ((R & ~31) + perm32(R & 31)) : R;
        voffA[i] = (unsigned)(R * lda + C) * 2u; voffB[i] = (unsigned)(Rb * K + C) * 2u; }
    const size_t kstep = (size_t)(BK * 2);
    const size_t hstepA = (size_t)HALF * lda * 2, hstepB = (size_t)HALF * K * 2;
    const size_t tstepA = 2 * hstepA, tstepB = 2 * hstepB;
    const unsigned ldsw = (unsigned)wid * 1024u;
    const int aoff = lds_byte(wr * 64 + fr, fq * 8), boff = lds_byte(wc * 32 + fr, fq * 8);
#define PG8_SA(b, h) (((b) * 2 + (h)) * HTB)
#define PG8_SB(b, h) ((4 + (b) * 2 + (h)) * HTB)
#define PG8_STAGE(bufoff, gbase, voff) do { _Pragma("unroll") for (int _i = 0; _i < 2; ++_i) \
        __builtin_amdgcn_global_load_lds((const unsigned*)((const char*)(gbase) + (voff)[_i]), (LAS unsigned*)(lds + (bufoff) + ldsw + _i * 8192), 16, 0, 0); } while (0)
#define PG8_LDA(dst, b, h) do { _Pragma("unroll") for (int m = 0; m < 4; ++m) _Pragma("unroll") for (int k = 0; k < 2; ++k) dst[m][k] = *(const LAS bf16x8*)(lds + PG8_SA(b, h) + aoff + m * 2048 + k * 1024); } while (0)
#define PG8_LDB(dst, b, h) do { _Pragma("unroll") for (int n = 0; n < 2; ++n) _Pragma("unroll") for (int k = 0; k < 2; ++k) dst[n][k] = *(const LAS bf16x8*)(lds + PG8_SB(b, h) + boff + n * 2048 + k * 1024); } while (0)
#define PG8_MMA(ai, bj, At, Bt) do { __builtin_amdgcn_s_setprio(1); _Pragma("unroll") for (int m = 0; m < 4; ++m) _Pragma("unroll") for (int n = 0; n < 2; ++n) _Pragma("unroll") for (int k = 0; k < 2; ++k) \
        acc[ai][bj][m][n] = __builtin_amdgcn_mfma_f32_16x16x32_bf16(Bt[n][k], At[m][k], acc[ai][bj][m][n], 0, 0, 0); __builtin_amdgcn_s_setprio(0); } while (0)
#define PG8_WAIT_V(n) asm volatile("s_waitcnt vmcnt(" #n ")" ::: "memory")
#define PG8_WAIT_L(n) asm volatile("s_waitcnt lgkmcnt(" #n ")" ::: "memory")
#define PG8_BAR __builtin_amdgcn_s_barrier()
#define PG8_SCHED __builtin_amdgcn_sched_barrier(0)
#define PG8_ABASE(u_) ((const char*)g.A + (size_t)(u_).pm * tstepA + (g.a_grp ? (size_t)(((u_).pn / g.a_grp) * g.a_grp_cols) * 2 : (size_t)0))
    Unit cur, nxt; int ui = 0;
    if (!S.next(0, cur)) return;
    f32x4 acc[2][2][4][2];
#pragma unroll
    for (int a = 0; a < 2; ++a)
#pragma unroll
        for (int b = 0; b < 2; ++b)
#pragma unroll
            for (int m = 0; m < 4; ++m)
#pragma unroll
                for (int n = 0; n < 2; ++n) acc[a][b][m][n] = (f32x4){0.f, 0.f, 0.f, 0.f};
    bf16x8 At[4][2], B0[2][2], B1[2][2];
    const char* cA = PG8_ABASE(cur); const char* cB = (const char*)g.Bt + (size_t)cur.pn * tstepB;
    PG8_STAGE(PG8_SB(0, 0), cB, voffB); PG8_STAGE(PG8_SB(0, 1), cB + hstepB, voffB); PG8_STAGE(PG8_SA(0, 0), cA, voffA); PG8_STAGE(PG8_SA(0, 1), cA + hstepA, voffA);
    if (wr == 1) PG8_BAR;
    PG8_WAIT_V(2); PG8_BAR;
    PG8_STAGE(PG8_SB(1, 0), cB + kstep, voffB); PG8_STAGE(PG8_SA(1, 0), cA + kstep, voffA); PG8_STAGE(PG8_SB(1, 1), cB + hstepB + kstep, voffB);
    PG8_WAIT_V(6); PG8_BAR;
    for (;;) {
        const bool has_next = S.next(ui + 1, nxt);
        const char* nA = has_next ? PG8_ABASE(nxt) : cA; const char* nB = has_next ? (const char*)g.Bt + (size_t)nxt.pn * tstepB : cB;
        for (int t = 0; t < nt; t += 2) {
            const bool last = (t == nt - 2);
            const char* a1 = cA + (size_t)(t + 1) * kstep;
            const char* a2 = last ? nA : cA + (size_t)(t + 2) * kstep; const char* b2 = last ? nB : cB + (size_t)(t + 2) * kstep;
            const char* a3 = a2 + kstep; const char* b3 = b2 + kstep;
            PG8_LDB(B0, 0, 0); PG8_LDB(B1, 0, 1); PG8_SCHED; PG8_LDA(At, 0, 0); PG8_STAGE(PG8_SA(1, 1), a1 + hstepA, voffA);
            PG8_WAIT_V(8); PG8_WAIT_L(0); PG8_BAR; PG8_MMA(0, 0, At, B0); PG8_MMA(0, 1, At, B1); PG8_BAR; PG8_SCHED;
            PG8_LDA(At, 0, 1); PG8_STAGE(PG8_SB(0, 0), b2, voffB); PG8_STAGE(PG8_SB(0, 1), b2 + hstepB, voffB); PG8_STAGE(PG8_SA(0, 0), a2, voffA);
            PG8_WAIT_V(8); PG8_WAIT_L(0); PG8_BAR; PG8_MMA(1, 0, At, B0); PG8_MMA(1, 1, At, B1); PG8_BAR; PG8_SCHED;
            PG8_LDB(B0, 1, 0); PG8_LDB(B1, 1, 1); PG8_SCHED; PG8_LDA(At, 1, 0); PG8_STAGE(PG8_SA(0, 1), a2 + hstepA, voffA);
            PG8_WAIT_V(8); PG8_WAIT_L(0); PG8_BAR; PG8_MMA(0, 0, At, B0); PG8_MMA(0, 1, At, B1); PG8_BAR; PG8_SCHED;
            PG8_LDA(At, 1, 1); PG8_STAGE(PG8_SB(1, 0), b3, voffB); PG8_STAGE(PG8_SB(1, 1), b3 + hstepB, voffB); PG8_STAGE(PG8_SA(1, 0), a3, voffA);
            PG8_WAIT_V(8); PG8_WAIT_L(0); PG8_BAR; PG8_MMA(1, 0, At, B0); PG8_MMA(1, 1, At, B1); PG8_BAR; PG8_SCHED;
        }
        if constexpr (ALIGN_EPI) { if (wr == 0) PG8_BAR; }
        E(acc, cur, wr, wc, fr, fq);
        if (!has_next) break;
#pragma unroll
        for (int a = 0; a < 2; ++a)
#pragma unroll
            for (int b = 0; b < 2; ++b)
#pragma unroll
                for (int m = 0; m < 4; ++m)
#pragma unroll
                    for (int n = 0; n < 2; ++n) acc[a][b][m][n] = (f32x4){0.f, 0.f, 0.f, 0.f};
        cur = nxt; cA = nA; cB = nB; ++ui;
        if constexpr (ALIGN_EPI) { if (wr == 1) PG8_BAR; }
    }
    PG8_WAIT_V(0);
    if constexpr (!ALIGN_EPI) { if (wr == 0) PG8_BAR; }
    PG8_BAR;
#undef PG8_SA
#undef PG8_SB
#undef PG8_STAGE
#undef PG8_LDA
#undef PG8_LDB
#undef PG8_MMA
#undef PG8_WAIT_V
#undef PG8_WAIT_L
#undef PG8_BAR
#undef PG8_SCHED
#undef PG8_ABASE
}
}

constexpr size_t MiB = 1u << 20;
constexpr size_t WS_CTL = 0, CTL_ZERO_BYTES = 64 * 1024;
constexpr size_t WS_WA = 1 * MiB;
constexpr size_t WA_WIN = 0, WA_WOUT = (size_t)EVEN_IN * D_MODEL * 2, WA_GLU = WA_WOUT + (size_t)D_MODEL * EVEN_OUT * 2;
constexpr size_t WS_WB = 16 * MiB;
constexpr size_t WB_WIN = 0, WB_POOL = (size_t)ODD_IN * D_MODEL * 2, WB_WOUT = WB_POOL + (size_t)POOL_W * 512 * 2;
constexpr size_t WS_TAB = 31 * MiB;
constexpr size_t TAB_ROPE = 0, TAB_KT = 128 * 1024, TAB_KT_LAYER = (size_t)32 * 33 * 256 * 2, TAB_WC = TAB_KT + 2 * TAB_KT_LAYER, TAB_WC_LAYER = (size_t)32 * 512 * 128 * 2;
static_assert(TAB_WC + 2 * TAB_WC_LAYER <= 10 * MiB, "tables");
constexpr size_t WS_H = 41 * MiB;
constexpr size_t WS_QM = 73 * MiB;
constexpr size_t WS_K = 121 * MiB, WS_V = 153 * MiB, WS_GA = 185 * MiB;
constexpr size_t WS_U2 = 217 * MiB;
constexpr size_t WS_GS = 233 * MiB;
constexpr size_t WS_YG = WS_H;
constexpr size_t WS_Y = WS_K;
constexpr size_t WS_MIX = 41 * MiB;
constexpr size_t WS_U = 105 * MiB;
constexpr size_t WS_SG = 169 * MiB;
constexpr size_t WS_YO = WS_U;
constexpr size_t WS_END = 249 * MiB;
static_assert(WS_GS + (size_t)M_TOK * 512 * 2 <= WS_END && WS_SG + (size_t)M_TOK * 2048 * 2 <= WS_END && WS_MIX + (size_t)M_TOK * 2048 * 2 <= WS_U, "ws map");
static_assert(WA_GLU + 512 * 512 * 2 <= 15 * MiB && WB_WOUT + (size_t)D_MODEL * POOL_W * 2 <= 15 * MiB, "weight slots");

constexpr int CW_BAR = 4096;
constexpr int SCR_BYTES = 146944, MISC_OFF = SCR_BYTES, LDS_BYTES = 147456;

#define XB_TMO      128
#define XB_XCNT(j)  (256  + 64 * (j))
#define XB_XSUB(j)  (1280 + 64 * (j))
#define XB_XGEN(j)  (2304 + 64 * (j))
#define XB_TOP      3328
#define XB_TOPGEN   3392
#define XCD_BAR_WORDS 3456
#define XB_SPIN_CAP (1u << 18)
__device__ __forceinline__ unsigned xb_ld(unsigned* p)              { return __hip_atomic_load(p, __ATOMIC_RELAXED, __HIP_MEMORY_SCOPE_AGENT); }
__device__ __forceinline__ unsigned xb_add(unsigned* p, unsigned v) { return __hip_atomic_fetch_add(p, v, __ATOMIC_RELAXED, __HIP_MEMORY_SCOPE_AGENT); }
__device__ __forceinline__ unsigned xb_xcc_id() { return (unsigned)__builtin_amdgcn_s_getreg((3 << 11) | 20) & 0xFu; }
#define XB_SPIN(cond, bar) do { unsigned _sp = 0; while (cond) { __builtin_amdgcn_s_sleep(1); \
    if ((++_sp & 255u) == 0u) { if (xb_ld(&(bar)[XB_TMO])) break; if (_sp > XB_SPIN_CAP) { atomicAdd(&(bar)[XB_TMO], 1u); break; } } } } while (0)
struct XcdBarrier { unsigned* bar; unsigned x; volatile LAS unsigned* st; };
__device__ __forceinline__ XcdBarrier xcd_barrier_post(unsigned* bar, volatile LAS unsigned* st) {
    XcdBarrier b; b.bar = bar; b.x = xb_xcc_id(); b.st = st;
    if (threadIdx.x == 0) (void)xb_add(&bar[XB_XCNT(b.x)], 1u);
    return b;
}
__device__ __forceinline__ void xcd_barrier_complete(unsigned* bar, unsigned x, unsigned& nloc, unsigned& nx) {
    const unsigned G = gridDim.x * gridDim.y * gridDim.z;
    unsigned sum, cnt, mine, sp = 0u;
    for (;;) {
        sum = 0u; cnt = 0u; mine = 0u;
#pragma unroll
        for (unsigned j = 0; j < 16; ++j) { const unsigned c = xb_ld(&bar[XB_XCNT(j)]); sum += c; cnt += (c > 0u) ? 1u : 0u; mine = (j == x) ? c : mine; }
        if (sum == G) break;
        __builtin_amdgcn_s_sleep(1);
        if ((++sp & 255u) == 0u) { if (xb_ld(&bar[XB_TMO])) break; if (sp > XB_SPIN_CAP) { atomicAdd(&bar[XB_TMO], 1u); break; } }
    }
    nloc = mine > 0u ? mine : 1u; nx = cnt > 0u ? cnt : 1u;
}
__device__ __forceinline__ void xcd_barrier(const XcdBarrier& b) {
    asm volatile("s_waitcnt vmcnt(0)" ::: "memory");
    __syncthreads();
    if (threadIdx.x == 0) {
        unsigned* bar = b.bar;
        __builtin_amdgcn_s_waitcnt(0);
        unsigned nloc = b.st[0], nx = b.st[1];
        if (nloc == 0u) { xcd_barrier_complete(bar, b.x, nloc, nx); b.st[0] = nloc; b.st[1] = nx; }
        const unsigned old = xb_add(&bar[XB_XSUB(b.x)], 1u);
        const unsigned gen = old / nloc;
        if (old + 1u == (gen + 1u) * nloc) {
            __builtin_amdgcn_fence(__ATOMIC_RELEASE, "agent");
            asm volatile("s_waitcnt vmcnt(0)" ::: "memory");
            const unsigned og = xb_add(&bar[XB_TOP], 1u);
            const unsigned tg = og / nx;
            if (og + 1u == (tg + 1u) * nx) xb_add(&bar[XB_TOPGEN], 1u);
            else XB_SPIN(xb_ld(&bar[XB_TOPGEN]) == tg, bar);
            __builtin_amdgcn_fence(__ATOMIC_ACQUIRE, "agent");
            xb_add(&bar[XB_XGEN(b.x)], 1u);
            asm volatile("s_waitcnt vmcnt(0)" ::: "memory");
        } else {
            XB_SPIN(xb_ld(&bar[XB_XGEN(b.x)]) == gen, bar);
            __builtin_amdgcn_fence(__ATOMIC_ACQUIRE, "agent");
            asm volatile("s_waitcnt vmcnt(0)" ::: "memory");
        }
    }
    __syncthreads();
}

struct Args { const float* in[19]; float* out; unsigned char* ws; int ph_lo, ph_hi; };
struct Frame {
    LAS unsigned char* lds; unsigned char* ldsg;
    int tid, lane, wave, vcu, G;
    unsigned char* ws; float* out;
    const float* x; const float *pre_norm, *post_norm, *even_w_in, *even_w_out, *a_re, *a_im, *log_dt, *b_re, *b_im, *c_re, *c_im, *ssm_d, *glu_w, *glu_b, *odd_w_in, *pool_w, *pool_scale, *odd_w_out;
};

__device__ __forceinline__ void transpose_item(const float* W, int K, int N, bf16_t* WT, int row_off, LAS float* scr, int item, int lane) {
    const int nblk = N / 32, kb = item / nblk, nb = item % nblk, k0 = 64 * kb, n0 = 32 * nb;
#pragma unroll 8
    for (int i = 0; i < 32; ++i) { const int kk = 2 * i + (lane >> 5); scr[kk * 33 + (lane & 31)] = W[(size_t)(k0 + kk) * N + n0 + (lane & 31)]; }
    asm volatile("s_waitcnt lgkmcnt(0)" ::: "memory");
    const int c = lane & 7;
#pragma unroll
    for (int j = 0; j < 4; ++j) { const int n = (lane >> 3) + 8 * j; const LAS float* s = scr + (8 * c) * 33 + n;
        u32x4 o; o.x = pk2(s[0 * 33], s[1 * 33]); o.y = pk2(s[2 * 33], s[3 * 33]); o.z = pk2(s[4 * 33], s[5 * 33]); o.w = pk2(s[6 * 33], s[7 * 33]);
        *(u32x4*)(WT + (size_t)(row_off + n0 + n) * K + k0 + 8 * c) = o; }
    asm volatile("s_waitcnt lgkmcnt(0)" ::: "memory");
}
__device__ __forceinline__ void convert_layer_weights(Frame& F, int layer, int gw, int NGW) {
    LAS float* scr = (LAS float*)(F.lds + F.wave * 16384);
    const int i = layer >> 1;
    if ((layer & 1) == 0) {
        bf16_t* base = (bf16_t*)(F.ws + WS_WA);
        constexpr int I1 = (D_MODEL / 64) * (EVEN_IN / 32), I2 = (EVEN_OUT / 64) * (D_MODEL / 32), I3 = (512 / 64) * (512 / 32);
        for (int it = gw; it < I1 + I2 + I3; it += NGW) {
            int r = it;
            if (r < I1) { transpose_item(F.even_w_in + (size_t)i * D_MODEL * EVEN_IN, D_MODEL, EVEN_IN, base + WA_WIN / 2, 0, scr, r, F.lane); continue; } r -= I1;
            if (r < I2) { transpose_item(F.even_w_out + (size_t)i * EVEN_OUT * D_MODEL, EVEN_OUT, D_MODEL, base + WA_WOUT / 2, 0, scr, r, F.lane); continue; } r -= I2;
            transpose_item(F.glu_w + (size_t)i * 512 * 512, 512, 512, base + WA_GLU / 2, 0, scr, r, F.lane);
        }
    } else {
        bf16_t* base = (bf16_t*)(F.ws + WS_WB);
        constexpr int I1 = (D_MODEL / 64) * (ODD_IN / 32), IP = (512 / 64) * (512 / 32), I3 = (POOL_W / 64) * (D_MODEL / 32);
        for (int it = gw; it < I1 + 4 * IP + I3; it += NGW) {
            int r = it;
            if (r < I1) { transpose_item(F.odd_w_in + (size_t)i * D_MODEL * ODD_IN, D_MODEL, ODD_IN, base + WB_WIN / 2, 0, scr, r, F.lane); continue; } r -= I1;
            if (r < 4 * IP) { const int g = r / IP; transpose_item(F.pool_w + ((size_t)i * 4 + g) * 512 * 512, 512, 512, base + WB_POOL / 2, g * 512, scr, r % IP, F.lane); continue; } r -= 4 * IP;
            transpose_item(F.odd_w_out + (size_t)i * POOL_W * D_MODEL, POOL_W, D_MODEL, base + WB_WOUT / 2, 0, scr, r, F.lane);
        }
    }
}

__device__ __forceinline__ void rms_row_to_bf16(const float* xrow, const float* gain, bf16_t* orow, int lane) {
    const f32x4* xr = (const f32x4*)xrow + lane; const f32x4* gr = (const f32x4*)gain + lane;
    f32x4 v[4]; float s = 0.f;
#pragma unroll
    for (int j = 0; j < 4; ++j) { v[j] = xr[64 * j]; s += (v[j].x * v[j].x + v[j].y * v[j].y) + (v[j].z * v[j].z + v[j].w * v[j].w); }
    const float r = 1.0f / sqrtf(wave_sum(s) * (1.f / D_MODEL) + RMS_EPS);
    u32x2* o8 = (u32x2*)orow + lane;
#pragma unroll
    for (int j = 0; j < 4; ++j) { const f32x4 g = gr[64 * j]; u32x2 w; w.x = pk2(v[j].x * r * g.x, v[j].y * r * g.y); w.y = pk2(v[j].z * r * g.z, v[j].w * r * g.w); o8[64 * j] = w; }
}
__device__ __forceinline__ void norm_phase(Frame& F, const float* Y, const float* xin, const float* gpost, const float* gpre_next, bf16_t* H) {
    const int gw = F.vcu * 8 + F.wave, NGW = F.G * 8, lane = F.lane;
    for (int m = gw; m < M_TOK; m += NGW) {
        const f32x4* yr = (const f32x4*)(Y + (size_t)m * D_MODEL) + lane; const f32x4* xr = (const f32x4*)(xin + (size_t)m * D_MODEL) + lane;
        f32x4 y[4], xv[4]; float s = 0.f;
#pragma unroll
        for (int j = 0; j < 4; ++j) { y[j] = yr[64 * j]; xv[j] = xr[64 * j]; s += (y[j].x * y[j].x + y[j].y * y[j].y) + (y[j].z * y[j].z + y[j].w * y[j].w); }
        const float r = 1.0f / sqrtf(wave_sum(s) * (1.f / D_MODEL) + RMS_EPS);
        float s2 = 0.f; f32x4* orow = (f32x4*)(F.out + (size_t)m * D_MODEL) + lane;
#pragma unroll
        for (int j = 0; j < 4; ++j) { const f32x4 g = ((const f32x4*)gpost + lane)[64 * j]; xv[j] = xv[j] + y[j] * r * g; orow[64 * j] = xv[j];
            s2 += (xv[j].x * xv[j].x + xv[j].y * xv[j].y) + (xv[j].z * xv[j].z + xv[j].w * xv[j].w); }
        if (gpre_next) {
            const float r2 = 1.0f / sqrtf(wave_sum(s2) * (1.f / D_MODEL) + RMS_EPS);
            u32x2* o8 = (u32x2*)(H + (size_t)m * D_MODEL) + lane;
#pragma unroll
            for (int j = 0; j < 4; ++j) { const f32x4 g = ((const f32x4*)gpre_next + lane)[64 * j]; u32x2 w; w.x = pk2(xv[j].x * r2 * g.x, xv[j].y * r2 * g.y); w.y = pk2(xv[j].z * r2 * g.z, xv[j].w * r2 * g.w); o8[64 * j] = w; }
        }
    }
}

struct cpx { float r, i; };
__device__ __forceinline__ cpx cmul(cpx a, cpx b) { return {a.r * b.r - a.i * b.i, a.r * b.i + a.i * b.r}; }
__device__ __forceinline__ cpx cexp_scaled(float ar, float ai, float s) {
    const float e = expf(s * ar); float sn, cs; sincosf(s * ai, &sn, &cs); return {e * cs, e * sn};
}
__device__ __forceinline__ cpx ssm_kappa(float ar, float ai, float dt) {
    const cpx lb = cexp_scaled(ar, ai, dt); const float nr = lb.r - 1.0f, ni = lb.i, den = 1.0f / (ar * ar + ai * ai);
    return {(nr * ar + ni * ai) * den, (ni * ar - nr * ai) * den};
}
__device__ __forceinline__ void p0_tables(Frame& F, int gw, int NGW) {
    float* rope = (float*)(F.ws + WS_TAB + TAB_ROPE);
    for (int idx = gw * 64 + F.lane; idx < SEQ * 8; idx += NGW * 64) {
        const int t = idx >> 3, i = idx & 7; const float inv = powf(500000.0f, -(float)i * 0.125f); const float ang = (float)t * inv;
        rope[t * 16 + i] = cosf(ang); rope[t * 16 + 8 + i] = sinf(ang);
    }
    LAS float* scr = (LAS float*)(F.lds + F.wave * 16384);
    for (int task = gw; task < 2 * 32 * 32; task += NGW) {
        const int tau = task & 31, g = (task >> 5) & 31, i = task >> 10, p = F.lane;
        const float dt = expf(F.log_dt[i * 32 + g]); const float ar = F.a_re[(i * 32 + g) * 64 + p], ai = F.a_im[(i * 32 + g) * 64 + p];
        const cpx om = cmul(cexp_scaled(ar, ai, dt * (float)tau), ssm_kappa(ar, ai, dt));
        asm volatile("s_waitcnt lgkmcnt(0)" ::: "memory");
        scr[2 * p] = om.r; scr[2 * p + 1] = om.i;
        asm volatile("s_waitcnt lgkmcnt(0)" ::: "memory");
        const int h = F.lane >> 2, hq = (F.lane & 3) * 4;
        const float* cr = F.c_re + ((size_t)(i * 32 + g) * 16 + h) * 64; const float* ci = F.c_im + ((size_t)(i * 32 + g) * 16 + h) * 64;
        const float* br = F.b_re + (size_t)(i * 32 + g) * 64 * 16 + hq; const float* bi = F.b_im + (size_t)(i * 32 + g) * 64 * 16 + hq;
        f32x4 acc = {0.f, 0.f, 0.f, 0.f};
        for (int pp = 0; pp < 64; ++pp) {
            const float wr_ = scr[2 * pp], wi_ = scr[2 * pp + 1]; const float c_r = cr[pp], c_i = ci[pp];
            const float er = c_r * wr_ - c_i * wi_, ei = c_r * wi_ + c_i * wr_;
            const f32x4 b_r = *(const f32x4*)(br + pp * 16), b_i = *(const f32x4*)(bi + pp * 16);
            acc = acc + b_r * er - b_i * ei;
        }
        bf16_t* kt = (bf16_t*)(F.ws + WS_TAB + TAB_KT + (size_t)i * TAB_KT_LAYER) + ((size_t)g * 33 + tau + 1) * 256 + h * 16 + hq;
        u32x2 w; w.x = pk2(acc.x, acc.y); w.y = pk2(acc.z, acc.w); *(u32x2*)kt = w;
        if (tau == 0) { bf16_t* kz = (bf16_t*)(F.ws + WS_TAB + TAB_KT + (size_t)i * TAB_KT_LAYER) + ((size_t)g * 33) * 256 + F.lane * 4; *(u32x2*)kz = (u32x2){0u, 0u}; }
    }
    for (int task = gw; task < 2 * 32 * 32; task += NGW) {
        const int ii = task & 31, g = (task >> 5) & 31, i = task >> 10, p = F.lane;
        const float dt = expf(F.log_dt[i * 32 + g]); const float ar = F.a_re[(i * 32 + g) * 64 + p], ai = F.a_im[(i * 32 + g) * 64 + p];
        const cpx pw = cexp_scaled(ar, ai, dt * (float)(ii + 1));
        bf16_t* wc = (bf16_t*)(F.ws + WS_TAB + TAB_WC + (size_t)i * TAB_WC_LAYER) + ((size_t)g * 512 + ii * 16) * 128;
#pragma unroll 4
        for (int h = 0; h < 16; ++h) {
            const float c_r = F.c_re[((size_t)(i * 32 + g) * 16 + h) * 64 + p], c_i = F.c_im[((size_t)(i * 32 + g) * 16 + h) * 64 + p];
            wc[h * 128 + p] = (bf16_t)f2bf(c_r * pw.r - c_i * pw.i); wc[h * 128 + 64 + p] = (bf16_t)f2bf(-(c_r * pw.i + c_i * pw.r));
        }
    }
}

__device__ __forceinline__ u32x4 pack8(f32x4 v0, f32x4 v1) { u32x4 w; w.x = pk2(v0[0], v0[1]); w.y = pk2(v0[2], v0[3]); w.z = pk2(v1[0], v1[1]); w.w = pk2(v1[2], v1[3]); return w; }

struct EpiEvenIn {
    static constexpr bool PERM = true;
    unsigned char* ws; const float* rope;
    __device__ __forceinline__ void operator()(const f32x4 (&acc)[2][2][4][2], const pg8::Unit& u, int wr, int wc, int fr, int fq) const {
        const int region = u.pn >> 2;
        const int row0 = u.pm * 256 + wr * 64 + fr;
#pragma unroll
        for (int ai = 0; ai < 2; ++ai)
#pragma unroll
            for (int m = 0; m < 4; ++m) {
                const int row = row0 + ai * 128 + m * 16;
#pragma unroll
                for (int bj = 0; bj < 2; ++bj) {
                    const int ct = (u.pn & 3) * 256 + bj * 128 + wc * 32 + 8 * fq;
                    f32x4 v0 = acc[ai][bj][m][0], v1 = acc[ai][bj][m][1];
                    if (region <= 1) {
                        if ((wc & 1) == 0) {
                            f32x4 p0, p1;
#pragma unroll
                            for (int e = 0; e < 4; ++e) { p0[e] = __shfl_xor(v0[e], 16); p1[e] = __shfl_xor(v1[e], 16); }
                            if (fq < 2) {
                                const float* rt = rope + (row & (SEQ - 1)) * 16;
                                const f32x4 c0 = *(const f32x4*)(rt), c1 = *(const f32x4*)(rt + 4), s0 = *(const f32x4*)(rt + 8), s1 = *(const f32x4*)(rt + 12);
                                const float sg = fq == 0 ? -1.f : 1.f;
                                v0 = v0 * c0 + p0 * s0 * sg; v1 = v1 * c1 + p1 * s1 * sg;
                            }
                        }
                        if (region == 0) { v0 = v0 * QSCALE; v1 = v1 * QSCALE; *(u32x4*)((bf16_t*)(ws + WS_QM) + (size_t)row * 1536 + ct) = pack8(v0, v1); }
                        else *(u32x4*)((bf16_t*)(ws + WS_K) + (size_t)row * 1024 + ct) = pack8(v0, v1);
                    } else if (region == 2) {
                        *(u32x4*)((bf16_t*)(ws + WS_V) + (size_t)row * 1024 + ct) = pack8(v0, v1);
                    } else if (region == 3) {
#pragma unroll
                        for (int e = 0; e < 4; ++e) { v0[e] = siluf_(v0[e]); v1[e] = siluf_(v1[e]); }
                        *(u32x4*)((bf16_t*)(ws + WS_GA) + (size_t)row * 1024 + ct) = pack8(v0, v1);
                    } else if (ct < 512) {
                        const int g = ct >> 4, hc = ct & 15;
                        *(u32x4*)((bf16_t*)(ws + WS_U2) + ((size_t)g * M_TOK + row) * 16 + hc) = pack8(v0, v1);
                    } else {
#pragma unroll
                        for (int e = 0; e < 4; ++e) { v0[e] = siluf_(v0[e]); v1[e] = siluf_(v1[e]); }
                        *(u32x4*)((bf16_t*)(ws + WS_GS) + (size_t)row * 512 + (ct - 512)) = pack8(v0, v1);
                    }
                }
            }
    }
};
struct EpiGlu {
    static constexpr bool PERM = true;
    unsigned char* ws; const float* bias;
    __device__ __forceinline__ void operator()(const f32x4 (&acc)[2][2][4][2], const pg8::Unit& u, int wr, int wc, int fr, int fq) const {
        const int row0 = u.pm * 256 + wr * 64 + fr;
#pragma unroll
        for (int ai = 0; ai < 2; ++ai)
#pragma unroll
            for (int m = 0; m < 4; ++m) {
                const int row = row0 + ai * 128 + m * 16;
#pragma unroll
                for (int bj = 0; bj < 2; ++bj) {
                    const int c = u.pn * 256 + bj * 128 + wc * 32 + 8 * fq;
                    const f32x4 b0 = *(const f32x4*)(bias + c), b1 = *(const f32x4*)(bias + c + 4);
                    const u32x4 yv = *(const u32x4*)((const bf16_t*)(ws + WS_YG) + (size_t)row * 512 + c), gv = *(const u32x4*)((const bf16_t*)(ws + WS_GS) + (size_t)row * 512 + c);
                    f32x4 v0 = acc[ai][bj][m][0] + b0, v1 = acc[ai][bj][m][1] + b1;
                    const unsigned yw[4] = {yv.x, yv.y, yv.z, yv.w}, gw_[4] = {gv.x, gv.y, gv.z, gv.w};
#pragma unroll
                    for (int e = 0; e < 2; ++e) {
                        v0[2 * e] = bflo(yw[e]) * sigmoidf_(v0[2 * e]) * bflo(gw_[e]); v0[2 * e + 1] = bfhi(yw[e]) * sigmoidf_(v0[2 * e + 1]) * bfhi(gw_[e]);
                        v1[2 * e] = bflo(yw[2 + e]) * sigmoidf_(v1[2 * e]) * bflo(gw_[2 + e]); v1[2 * e + 1] = bfhi(yw[2 + e]) * sigmoidf_(v1[2 * e + 1]) * bfhi(gw_[2 + e]);
                    }
                    *(u32x4*)((bf16_t*)(ws + WS_QM) + (size_t)row * 1536 + 1024 + c) = pack8(v0, v1);
                }
            }
    }
};
struct EpiOddIn {
    static constexpr bool PERM = true;
    unsigned char* ws;
    __device__ __forceinline__ void operator()(const f32x4 (&acc)[2][2][4][2], const pg8::Unit& u, int wr, int wc, int fr, int fq) const {
        const bool gate = u.pn >= 8; const int row0 = u.pm * 256 + wr * 64 + fr;
        bf16_t* base = (bf16_t*)(ws + (gate ? WS_SG : WS_U));
#pragma unroll
        for (int ai = 0; ai < 2; ++ai)
#pragma unroll
            for (int m = 0; m < 4; ++m) {
                const int row = row0 + ai * 128 + m * 16;
#pragma unroll
                for (int bj = 0; bj < 2; ++bj) {
                    const int c = (u.pn & 7) * 256 + bj * 128 + wc * 32 + 8 * fq;
                    f32x4 v0 = acc[ai][bj][m][0], v1 = acc[ai][bj][m][1];
                    if (gate) {
#pragma unroll
                        for (int e = 0; e < 4; ++e) { v0[e] = siluf_(v0[e]); v1[e] = siluf_(v1[e]); }
                    }
                    *(u32x4*)(base + (size_t)row * 2048 + c) = pack8(v0, v1);
                }
            }
    }
};
struct EpiPool {
    static constexpr bool PERM = true;
    unsigned char* ws; const float* scale;
    __device__ __forceinline__ void operator()(const f32x4 (&acc)[2][2][4][2], const pg8::Unit& u, int wr, int wc, int fr, int fq) const {
        const int row0 = u.pm * 256 + wr * 64 + fr;
#pragma unroll
        for (int ai = 0; ai < 2; ++ai)
#pragma unroll
            for (int m = 0; m < 4; ++m) {
                const int row = row0 + ai * 128 + m * 16;
#pragma unroll
                for (int bj = 0; bj < 2; ++bj) {
                    const int c = u.pn * 256 + bj * 128 + wc * 32 + 8 * fq;
                    const f32x4 s0 = *(const f32x4*)(scale + c), s1 = *(const f32x4*)(scale + c + 4);
                    bf16_t* p = (bf16_t*)(ws + WS_SG) + (size_t)row * 2048 + c;
                    const u32x4 gv = *(const u32x4*)p; const unsigned gw_[4] = {gv.x, gv.y, gv.z, gv.w};
                    f32x4 v0 = acc[ai][bj][m][0] * s0, v1 = acc[ai][bj][m][1] * s1;
#pragma unroll
                    for (int e = 0; e < 2; ++e) { v0[2 * e] *= bflo(gw_[e]); v0[2 * e + 1] *= bfhi(gw_[e]); v1[2 * e] *= bflo(gw_[2 + e]); v1[2 * e + 1] *= bfhi(gw_[2 + e]); }
                    *(u32x4*)p = pack8(v0, v1);
                }
            }
    }
};
struct EpiF32 {
    static constexpr bool PERM = false;
    float* O; int ldc;
    __device__ __forceinline__ void operator()(const f32x4 (&acc)[2][2][4][2], const pg8::Unit& u, int wr, int wc, int fr, int fq) const {
        const int row0 = u.pm * 256 + wr * 64 + fr, col0 = u.pn * 256 + wc * 32 + 4 * fq;
#pragma unroll
        for (int ai = 0; ai < 2; ++ai)
#pragma unroll
            for (int m = 0; m < 4; ++m) { float* rowp = O + (size_t)(row0 + ai * 128 + m * 16) * ldc + col0;
#pragma unroll
                for (int bj = 0; bj < 2; ++bj)
#pragma unroll
                    for (int n = 0; n < 2; ++n) *(f32x4*)(rowp + bj * 128 + n * 16) = acc[ai][bj][m][n]; }
    }
};

__device__ __forceinline__ void pool_phase(Frame& F) {
    const int gw = F.vcu * 8 + F.wave, NGW = F.G * 8, lane = F.lane;
    const bf16_t* U = (const bf16_t*)(F.ws + WS_U); bf16_t* MX = (bf16_t*)(F.ws + WS_MIX);
    for (int task = gw; task < 4 * (M_TOK / 32); task += NGW) {
        const int g = task & 3, tb = task >> 2, row0 = tb * 32, t0 = row0 & (SEQ - 1), w = 2 << g;
        const int col = g * 512 + lane * 8;
        float s[8];
#pragma unroll
        for (int e = 0; e < 8; ++e) s[e] = 0.f;
        for (int d = w - 1; d >= 1; --d) {
            if (t0 - d >= 0) { const u32x4 v = *(const u32x4*)(U + (size_t)(row0 - d) * 2048 + col); const unsigned vw[4] = {v.x, v.y, v.z, v.w};
#pragma unroll
                for (int e = 0; e < 4; ++e) { s[2 * e] += bflo(vw[e]); s[2 * e + 1] += bfhi(vw[e]); } }
        }
        for (int j = 0; j < 32; ++j) {
            const int t = t0 + j;
            const u32x4 v = *(const u32x4*)(U + (size_t)(row0 + j) * 2048 + col); const unsigned vw[4] = {v.x, v.y, v.z, v.w};
            float cur[8];
#pragma unroll
            for (int e = 0; e < 4; ++e) { cur[2 * e] = bflo(vw[e]); cur[2 * e + 1] = bfhi(vw[e]); }
#pragma unroll
            for (int e = 0; e < 8; ++e) s[e] += cur[e];
            const float inv = 1.0f / (float)((t + 1) < w ? (t + 1) : w);
            f32x4 o0, o1;
#pragma unroll
            for (int e = 0; e < 4; ++e) { o0[e] = s[e] * inv - cur[e]; o1[e] = s[4 + e] * inv - cur[4 + e]; }
            *(u32x4*)(MX + (size_t)(row0 + j) * 2048 + col) = pack8(o0, o1);
            if (t - w + 1 >= 0) { const u32x4 q = *(const u32x4*)(U + (size_t)(row0 + j - w + 1) * 2048 + col); const unsigned qw[4] = {q.x, q.y, q.z, q.w};
#pragma unroll
                for (int e = 0; e < 4; ++e) { s[2 * e] -= bflo(qw[e]); s[2 * e + 1] -= bfhi(qw[e]); } }
        }
    }
}

constexpr int SU_U = 0, SU_CH = 1040, SU_KT = 64 * SU_CH  , SU_SB = SU_KT + 33 * 512  , SU_XI = SU_SB + 64 * 128 * 4  , SU_XROW = 272, SU_END = SU_XI + 64 * SU_XROW;
static_assert(SU_END <= SCR_BYTES, "ssm lds");
__device__ __forceinline__ void ssm_unit(Frame& F, int li, int b, int g) {
    LAS unsigned char* lds = F.lds; const int tid = F.tid, lane = F.lane, wave = F.wave, l31 = lane & 31, hh = lane >> 5;
    { const u32x4* src = (const u32x4*)((const bf16_t*)(F.ws + WS_U2) + ((size_t)g * M_TOK + (size_t)b * SEQ) * 16);
#pragma unroll
      for (int it = 0; it < 8; ++it) { const int q = it * 512 + tid, tok = q >> 1, half = q & 1; *(LAS u32x4*)(lds + SU_U + (tok >> 5) * SU_CH + (tok & 31) * 32 + half * 16) = src[q]; }
      const u32x4* ks = (const u32x4*)((const bf16_t*)(F.ws + WS_TAB + TAB_KT + (size_t)li * TAB_KT_LAYER) + (size_t)g * 33 * 256);
      for (int q = tid; q < 33 * 32; q += 512) *(LAS u32x4*)(lds + SU_KT + q * 16) = ks[q]; }
    const float dt = expf(F.log_dt[li * 32 + g]);
    cpx lam[2], lam4[2], lam8[2];
    bf16x8 bq[4];
#pragma unroll
    for (int pb = 0; pb < 2; ++pb) {
        const int p = l31 + 32 * pb; const float ar = F.a_re[(li * 32 + g) * 64 + p], ai = F.a_im[(li * 32 + g) * 64 + p];
        lam[pb] = cexp_scaled(ar, ai, dt); lam4[pb] = cexp_scaled(ar, ai, 4.f * dt); lam8[pb] = cexp_scaled(ar, ai, 8.f * dt);
        const cpx kap = ssm_kappa(ar, ai, dt);
        const float* br = F.b_re + ((size_t)(li * 32 + g) * 64 + p) * 16 + 8 * hh; const float* bi = F.b_im + ((size_t)(li * 32 + g) * 64 + p) * 16 + 8 * hh;
#pragma unroll
        for (int j = 0; j < 8; ++j) { const float re = kap.r * br[j] - kap.i * bi[j], im = kap.r * bi[j] + kap.i * br[j]; bq[pb][j] = (short)f2bf(re); bq[2 + pb][j] = (short)f2bf(im); }
    }
    __syncthreads();
    for (int c = wave; c < 64; c += 8) {
        const bf16x8 af = *(const LAS bf16x8*)(lds + SU_U + c * SU_CH + l31 * 32 + hh * 16);
        f32x16 bu[4]; const f32x16 z = {0.f, 0.f, 0.f, 0.f, 0.f, 0.f, 0.f, 0.f, 0.f, 0.f, 0.f, 0.f, 0.f, 0.f, 0.f, 0.f};
#pragma unroll
        for (int nt = 0; nt < 4; ++nt) bu[nt] = __builtin_amdgcn_mfma_f32_32x32x16_bf16(af, bq[nt], z, 0, 0, 0);
#pragma unroll
        for (int pb = 0; pb < 2; ++pb) {
            cpx P = {0.f, 0.f};
#pragma unroll
            for (int q = 0; q < 4; ++q) {
                cpx s4 = {0.f, 0.f};
#pragma unroll
                for (int e = 0; e < 4; ++e) { const cpx t = cmul(s4, lam[pb]); s4.r = t.r + bu[pb][4 * q + e]; s4.i = t.i + bu[2 + pb][4 * q + e]; }
                const cpx t = cmul(P, lam8[pb]); P.r = t.r + s4.r; P.i = t.i + s4.i;
            }
            const float orr = swap_half(P.r), oi = swap_half(P.i);
            const cpx P0 = hh ? (cpx){orr, oi} : P, P1 = hh ? P : (cpx){orr, oi};
            const cpx t = cmul(P0, lam4[pb]);
            if (hh == pb) { LAS float* sb = (LAS float*)(lds + SU_SB) + c * 128; sb[l31 + 32 * pb] = t.r + P1.r; sb[64 + l31 + 32 * pb] = t.i + P1.i; }
        }
    }
    __syncthreads();
    if (wave == 0) {
        const int p = lane; const float ar = F.a_re[(li * 32 + g) * 64 + p], ai = F.a_im[(li * 32 + g) * 64 + p];
        const cpx l32 = cexp_scaled(ar, ai, 32.f * dt); cpx x = {0.f, 0.f};
        for (int c = 0; c < 64; ++c) {
            LAS bf16_t* xi = (LAS bf16_t*)(lds + SU_XI + c * SU_XROW); xi[p] = (bf16_t)f2bf(x.r); xi[64 + p] = (bf16_t)f2bf(x.i);
            const LAS float* sb = (const LAS float*)(lds + SU_SB) + c * 128; const cpx t = cmul(x, l32); x.r = t.r + sb[p]; x.i = t.i + sb[64 + p];
        }
    }
    __syncthreads();
    const int il = l31 >> 4, h = l31 & 15; const float dsk = F.ssm_d[li * 512 + g * 16 + h];
    const bf16_t* wcg = (const bf16_t*)(F.ws + WS_TAB + TAB_WC + (size_t)li * TAB_WC_LAYER) + (size_t)g * 512 * 128;
    bf16_t* yg = (bf16_t*)(F.ws + WS_YG) + (size_t)b * SEQ * 512 + g * 16 + h;
#pragma unroll 1
    for (int sel = 0; sel < 2; ++sel) {
        const int ip = sel ? 15 - wave : wave;
        f32x16 a0 = {0.f, 0.f, 0.f, 0.f, 0.f, 0.f, 0.f, 0.f, 0.f, 0.f, 0.f, 0.f, 0.f, 0.f, 0.f, 0.f}, a1 = a0;
        for (int j = 0; j <= 2 * ip + 1; ++j) {
            const bf16x8 u0 = *(const LAS bf16x8*)(lds + SU_U + l31 * SU_CH + j * 32 + hh * 16), u1 = *(const LAS bf16x8*)(lds + SU_U + (32 + l31) * SU_CH + j * 32 + hh * 16);
            const bf16x8 kb = *(const LAS bf16x8*)(lds + SU_KT + (2 * ip + il - j + 1) * 512 + h * 32 + hh * 16);
            a0 = __builtin_amdgcn_mfma_f32_32x32x16_bf16(u0, kb, a0, 0, 0, 0); a1 = __builtin_amdgcn_mfma_f32_32x32x16_bf16(u1, kb, a1, 0, 0, 0);
        }
#pragma unroll
        for (int s = 0; s < 8; ++s) {
            const bf16x8 x0 = *(const LAS bf16x8*)(lds + SU_XI + l31 * SU_XROW + s * 32 + hh * 16), x1 = *(const LAS bf16x8*)(lds + SU_XI + (32 + l31) * SU_XROW + s * 32 + hh * 16);
            const bf16x8 wb = *(const bf16x8*)(wcg + (size_t)((2 * ip + il) * 16 + h) * 128 + s * 16 + hh * 8);
            a0 = __builtin_amdgcn_mfma_f32_32x32x16_bf16(x0, wb, a0, 0, 0, 0); a1 = __builtin_amdgcn_mfma_f32_32x32x16_bf16(x1, wb, a1, 0, 0, 0);
        }
#pragma unroll
        for (int r = 0; r < 16; ++r) {
            const int ch0 = (r & 3) + 8 * (r >> 2) + 4 * hh, tokl = 2 * ip + il;
            const float u0 = bf2f(*(const LAS bf16_t*)(lds + SU_U + ch0 * SU_CH + tokl * 32 + h * 2)), u1 = bf2f(*(const LAS bf16_t*)(lds + SU_U + (32 + ch0) * SU_CH + tokl * 32 + h * 2));
            yg[(size_t)(ch0 * 32 + tokl) * 512] = (bf16_t)f2bf(gelu_tanh(a0[r] + dsk * u0));
            yg[(size_t)((32 + ch0) * 32 + tokl) * 512] = (bf16_t)f2bf(gelu_tanh(a1[r] + dsk * u1));
        }
    }
    __syncthreads();
}

constexpr int AT_PA = 0, AT_PROW = 136, AT_PA_BYTES = 16 * 33 * AT_PROW  , AT_ST = AT_PA_BYTES, AT_ST_BYTES = 512 * 8, AT_V = AT_ST + AT_ST_BYTES  , AT_VW = 8192, AT_END = AT_V + 8 * AT_VW;
static_assert(AT_END <= SCR_BYTES && (AT_V % 1024) == 0 || true, "attn lds");
struct TileDesc { int kt0, ks, lo, hi; bool mask; };

struct AttnWave {
    bf16x8 qf[4]; f32x16 o0, o1; float m, l; int qtok;
};
__device__ __forceinline__ void attn_issue(const bf16_t* Kh, const bf16_t* Vh, const TileDesc& d, bf16x8 (&kf)[4], LAS unsigned char* vbuf, int lane) {
    const int l31 = lane & 31, hh = lane >> 5;
#pragma unroll
    for (int dh = 0; dh < 2; ++dh)
#pragma unroll
        for (int kg = 0; kg < 2; ++kg) {
            int tok = d.kt0 + (kg * 16 + (lane >> 2)) * d.ks; tok = tok < 0 ? 0 : tok;
            __builtin_amdgcn_global_load_lds((const unsigned*)(Vh + (size_t)tok * 1024 + dh * 32 + (lane & 3) * 8), (LAS unsigned*)(vbuf + dh * 2048 + kg * 1024), 16, 0, 0);
        }
    int tok = d.kt0 + l31 * d.ks; tok = tok < 0 ? 0 : tok;
    const bf16_t* kr = Kh + (size_t)tok * 1024 + hh * 8;
#pragma unroll
    for (int s = 0; s < 4; ++s) kf[s] = *(const bf16x8*)(kr + s * 16);
}
__device__ __forceinline__ void attn_compute(AttnWave& W, const TileDesc& d, const bf16x8 (&kf)[4], const LAS unsigned char* vbuf, int lane) {
    const int hh = lane >> 5;
    f32x16 s = {0.f, 0.f, 0.f, 0.f, 0.f, 0.f, 0.f, 0.f, 0.f, 0.f, 0.f, 0.f, 0.f, 0.f, 0.f, 0.f};
#pragma unroll
    for (int k = 0; k < 4; ++k) s = __builtin_amdgcn_mfma_f32_32x32x16_bf16(kf[k], W.qf[k], s, 0, 0, 0);
    if (d.mask) {
        const int hi_eff = d.hi < W.qtok ? d.hi : W.qtok;
        const int ob = W.qtok - d.kt0 - 4 * hh * d.ks; const unsigned span = (unsigned)(hi_eff - d.lo);
#pragma unroll
        for (int r = 0; r < 16; ++r) { const int o = ob - ((r & 3) + 8 * (r >> 2)) * d.ks; if ((unsigned)(o - d.lo) > span) s[r] = -INFINITY; }
    }
    float mx = s[0];
#pragma unroll
    for (int r = 1; r < 16; ++r) mx = fmaxf(mx, s[r]);
    mx = fmaxf(mx, swap_half(mx));
    const float mn = fmaxf(W.m, mx), mm = (mn == -INFINITY) ? 0.f : mn;
    const float alpha = __builtin_amdgcn_exp2f(W.m - mm);
    W.m = mn;
    float ps = 0.f;
#pragma unroll
    for (int r = 0; r < 16; ++r) { s[r] = __builtin_amdgcn_exp2f(s[r] - mm); ps += s[r]; }
    W.l = W.l * alpha + ps;
    if (!__all(alpha == 1.0f)) {
#pragma unroll
        for (int r = 0; r < 16; ++r) { W.o0[r] *= alpha; W.o1[r] *= alpha; }
    }
    bf16x8 pb[2];
#pragma unroll
    for (int k = 0; k < 2; ++k)
#pragma unroll
        for (int j = 0; j < 8; ++j) pb[k][j] = (short)f2bf(s[8 * k + j]);
    const LAS unsigned char* vb = vbuf + (4 * hh + ((lane & 15) >> 2)) * 64 + ((lane >> 4) & 1) * 32 + (lane & 3) * 8;
#pragma unroll
    for (int dh = 0; dh < 2; ++dh)
#pragma unroll
        for (int k2 = 0; k2 < 2; ++k2) {
            const s16x4 lo = __builtin_bit_cast(s16x4, __builtin_amdgcn_ds_read_tr16_b64_v4i16((LAS s16x4*)(vb + dh * 2048 + k2 * 1024)));
            const s16x4 hi = __builtin_bit_cast(s16x4, __builtin_amdgcn_ds_read_tr16_b64_v4i16((LAS s16x4*)(vb + dh * 2048 + k2 * 1024 + 512)));
            const bf16x8 vf = {lo[0], lo[1], lo[2], lo[3], hi[0], hi[1], hi[2], hi[3]};
            if (dh == 0) W.o0 = __builtin_amdgcn_mfma_f32_32x32x16_bf16(vf, pb[k2], W.o0, 0, 0, 0);
            else W.o1 = __builtin_amdgcn_mfma_f32_32x32x16_bf16(vf, pb[k2], W.o1, 0, 0, 0);
        }
}
template <class Gen>
__device__ __forceinline__ void attn_run(AttnWave& W, const bf16_t* Kh, const bf16_t* Vh, LAS unsigned char* vbuf2, int lane, int NT, const Gen& gen) {
    TileDesc dc, dn; bf16x8 kc[4], kn[4];
    int n = 0; while (n < NT && !gen(n, dc)) ++n;
    if (n >= NT) return;
    int par = 0;
    attn_issue(Kh, Vh, dc, kc, vbuf2, lane);
    for (;;) {
        int n2 = n + 1; while (n2 < NT && !gen(n2, dn)) ++n2;
        const bool more = n2 < NT;
        if (more) { attn_issue(Kh, Vh, dn, kn, vbuf2 + (par ^ 1) * 4096, lane); asm volatile("s_waitcnt vmcnt(8)" ::: "memory"); }
        else asm volatile("s_waitcnt vmcnt(0)" ::: "memory");
        attn_compute(W, dc, kc, vbuf2 + par * 4096, lane);
        if (!more) break;
        asm volatile("s_waitcnt lgkmcnt(0)" ::: "memory");
        dc = dn;
#pragma unroll
        for (int k = 0; k < 4; ++k) kc[k] = kn[k];
        par ^= 1; n = n2;
    }
    asm volatile("s_waitcnt lgkmcnt(0)" ::: "memory");
}
__device__ __forceinline__ void attn_load_q(AttnWave& W, const bf16_t* Qh  , int tok, int lane) {
    const bf16_t* qr = Qh + (size_t)tok * 1536 + (lane >> 5) * 8;
#pragma unroll
    for (int s = 0; s < 4; ++s) W.qf[s] = *(const bf16x8*)(qr + s * 16);
    const f32x16 z = {0.f, 0.f, 0.f, 0.f, 0.f, 0.f, 0.f, 0.f, 0.f, 0.f, 0.f, 0.f, 0.f, 0.f, 0.f, 0.f};
    W.o0 = z; W.o1 = z; W.m = -INFINITY; W.l = 0.f; W.qtok = tok;
}
__device__ __forceinline__ void attn_unit(Frame& F, int b, int h, int bk) {
    LAS unsigned char* lds = F.lds; const int lane = F.lane, wave = F.wave, l31 = lane & 31, hh = lane >> 5;
    bf16_t* QMh = (bf16_t*)(F.ws + WS_QM) + (size_t)b * SEQ * 1536 + h * 64;
    const bf16_t* Kh = (const bf16_t*)(F.ws + WS_K) + (size_t)b * SEQ * 1024 + h * 64;
    const bf16_t* Vh = (const bf16_t*)(F.ws + WS_V) + (size_t)b * SEQ * 1024 + h * 64;
    const bf16_t* GAh = (const bf16_t*)(F.ws + WS_GA) + (size_t)b * SEQ * 1024 + h * 64;
    LAS unsigned char* vbuf = lds + AT_V + wave * AT_VW;
    AttnWave W;
#pragma unroll 1
    for (int qt = 0; qt < 2; ++qt) {
        const int t0 = bk * 512 + (wave * 2 + qt) * 32;
        attn_load_q(W, QMh, t0 + l31, lane);
        attn_run(W, Kh, Vh, vbuf, lane, 5, [&](int n, TileDesc& d) -> bool {
            d.kt0 = t0 - 128 + 32 * n; d.ks = 1; d.lo = 0; d.hi = 128; d.mask = (n == 0) || (n == 4) || (d.kt0 < 0); return d.kt0 + 31 >= 0; });
        const float lt = W.l + swap_half(W.l), inv = 1.0f / lt;
        const int ql = (wave * 2 + qt) * 32 + l31, prow = (ql & 15) * 33 + (ql >> 4);
        LAS unsigned char* pr = lds + AT_PA + prow * AT_PROW;
#pragma unroll
        for (int g4 = 0; g4 < 4; ++g4) {
            u32x2 w0, w1; w0.x = pk2(W.o0[4 * g4] * inv, W.o0[4 * g4 + 1] * inv); w0.y = pk2(W.o0[4 * g4 + 2] * inv, W.o0[4 * g4 + 3] * inv);
            w1.x = pk2(W.o1[4 * g4] * inv, W.o1[4 * g4 + 1] * inv); w1.y = pk2(W.o1[4 * g4 + 2] * inv, W.o1[4 * g4 + 3] * inv);
            *(LAS u32x2*)(pr + (8 * g4 + 4 * hh) * 2) = w0; *(LAS u32x2*)(pr + (32 + 8 * g4 + 4 * hh) * 2) = w1;
        }
        if (hh == 0) *(LAS f32x2*)(lds + AT_ST + ql * 8) = (f32x2){W.m, lt};
    }
    __syncthreads();
#pragma unroll 1
    for (int rs = 0; rs < 2; ++rs) {
        const int r = wave * 2 + rs, I0 = bk * 32;
        const int qtok = bk * 512 + 16 * l31 + r;
        attn_load_q(W, QMh, qtok, lane);
        const int n3 = bk + 1;
        attn_run(W, Kh, Vh, vbuf, lane, n3 + 8, [&](int n, TileDesc& d) -> bool {
            d.ks = 16; d.lo = 0;
            if (n < n3) { d.kt0 = 512 * n + r; d.hi = 4096; d.mask = (n == n3 - 1); return true; }
            const int q = n - n3, e = q >> 1, second = q & 1; int rc = r - 4 * e; if (rc < 0) rc += 16;
            const int i0 = I0 - 32 + 32 * second;
            d.kt0 = 16 * i0 + rc; d.hi = 512; d.mask = true; return i0 >= 0; });
        const float lB = W.l + swap_half(W.l);
        const int ql = 16 * l31 + r, prow = r * 33 + l31;
        const f32x2 st = *(const LAS f32x2*)(lds + AT_ST + ql * 8);
        const float M = fmaxf(st.x, W.m), wA = st.y * __builtin_amdgcn_exp2f(st.x - M), wB = __builtin_amdgcn_exp2f(W.m - M);
        const float inv = 1.0f / (wA + lB * wB), cA = wA * inv, cB = wB * inv;
        const LAS unsigned char* pr = lds + AT_PA + prow * AT_PROW;
        bf16_t* orow = QMh + (size_t)qtok * 1536; const bf16_t* grow = GAh + (size_t)qtok * 1024;
#pragma unroll
        for (int g4 = 0; g4 < 4; ++g4)
#pragma unroll
            for (int dh = 0; dh < 2; ++dh) {
                const int dcol = dh * 32 + 8 * g4 + 4 * hh;
                const u32x2 pa = *(const LAS u32x2*)(pr + dcol * 2); const u32x2 ga = *(const u32x2*)(grow + dcol);
                float o[4];
#pragma unroll
                for (int e = 0; e < 4; ++e) o[e] = (dh ? W.o1[4 * g4 + e] : W.o0[4 * g4 + e]) * cB;
                o[0] = (o[0] + bflo(pa.x) * cA) * bflo(ga.x); o[1] = (o[1] + bfhi(pa.x) * cA) * bfhi(ga.x);
                o[2] = (o[2] + bflo(pa.y) * cA) * bflo(ga.y); o[3] = (o[3] + bfhi(pa.y) * cA) * bfhi(ga.y);
                u32x2 w; w.x = pk2(o[0], o[1]); w.y = pk2(o[2], o[3]); *(u32x2*)(orow + dcol) = w;
            }
    }
    __syncthreads();
}

constexpr int N_PHASES = 1 + 5 * DEPTH;
__global__ void __launch_bounds__(512, 2) hybrid_fwd(Args args) {
    extern __shared__ __attribute__((aligned(16))) unsigned char lds_raw[];
    Frame F;
    F.ldsg = lds_raw; F.lds = (LAS unsigned char*)lds_raw;
    F.tid = threadIdx.x; F.lane = F.tid & 63; F.wave = __builtin_amdgcn_readfirstlane(F.tid >> 6);
    F.G = gridDim.x; { const int bx = blockIdx.x; F.vcu = (F.G % 8 == 0) ? (bx % 8) * (F.G / 8) + bx / 8 : bx; }
    F.ws = args.ws; F.out = args.out;
    F.x = args.in[0]; F.pre_norm = args.in[1]; F.post_norm = args.in[2]; F.even_w_in = args.in[3]; F.even_w_out = args.in[4]; F.a_re = args.in[5]; F.a_im = args.in[6]; F.log_dt = args.in[7];
    F.b_re = args.in[8]; F.b_im = args.in[9]; F.c_re = args.in[10]; F.c_im = args.in[11]; F.ssm_d = args.in[12]; F.glu_w = args.in[13]; F.glu_b = args.in[14];
    F.odd_w_in = args.in[15]; F.pool_w = args.in[16]; F.pool_scale = args.in[17]; F.odd_w_out = args.in[18];
    volatile LAS unsigned* MISC = (volatile LAS unsigned*)(F.lds + MISC_OFF);
    for (int u = F.tid; u < (LDS_BYTES - MISC_OFF) / 4; u += 512) MISC[u] = 0u;
    __syncthreads();
#if MK_ONE_LAUNCH
    XcdBarrier bar = xcd_barrier_post((unsigned*)(F.ws + WS_CTL) + CW_BAR, MISC + 8);
#define GRID_BAR() xcd_barrier(bar)
#else
#define GRID_BAR() do {} while (0)
#endif
    const int lo = args.ph_lo, hi = args.ph_hi;
    const int gw = F.vcu * 8 + F.wave, NGW = F.G * 8;
    unsigned char* ws = F.ws;
#ifndef PH_MASK
#define PH_MASK 0xFFFFFFFFu
#endif
#define PHE(id) (((PH_MASK) >> (id)) & 1u)
    for (int ph = lo; ph < hi; ++ph) {
        { int tv = threadIdx.x; asm volatile("" : "+v"(tv)); F.tid = tv; F.lane = tv & 63; F.wave = __builtin_amdgcn_readfirstlane(tv >> 6);
          size_t wz = 0; asm volatile("" : "+s"(wz)); unsigned char* wv = args.ws + wz; F.ws = wv; ws = wv; }
        if (ph == 0) { if (PHE(0)) {
            p0_tables(F, gw, NGW);
            convert_layer_weights(F, 0, gw, NGW); convert_layer_weights(F, 1, gw, NGW);
            for (int m = gw; m < M_TOK; m += NGW) rms_row_to_bf16(F.x + (size_t)m * D_MODEL, F.pre_norm, (bf16_t*)(ws + WS_H) + (size_t)m * D_MODEL, F.lane);
        } } else {
            const int layer = (ph - 1) / 5, sub = (ph - 1) % 5, li = layer >> 1;
            if ((layer & 1) == 0) {
                if (sub == 0) { if (PHE(1)) {
                    pg8::Gemm g{(const bf16_t*)(ws + WS_H), (const bf16_t*)(ws + WS_WA + WA_WIN), M_TOK, EVEN_IN, D_MODEL, D_MODEL, 0, 0};
                    pg8::StaticOrder S; S.init(M_TOK, EVEN_IN, F.G, (int)blockIdx.x);
                    EpiEvenIn E{ws, (const float*)(ws + WS_TAB + TAB_ROPE)};
                    pg8::gemm_phase<EpiEvenIn, true>(F.lds, g, S, E, F.tid); }
                } else if (sub == 1) { if (PHE(2)) {
                    for (int pr = F.vcu; pr < 256; pr += F.G) {
                        const int bh = pr >> 1, odd = pr & 1;
#if !defined(NO_ATTN)
                        attn_unit(F, bh >> 4, bh & 15, odd ? 1 : 0);
                        attn_unit(F, bh >> 4, bh & 15, odd ? 2 : 3);
#endif
                    }
#if !defined(NO_SSM)
                    { int tv = threadIdx.x; asm volatile("" : "+v"(tv)); F.tid = tv; F.lane = tv & 63; F.wave = __builtin_amdgcn_readfirstlane(tv >> 6); }
                    for (int su = F.vcu; su < 256; su += F.G) ssm_unit(F, li, su >> 5, su & 31);
#endif
                    if (layer + 1 < DEPTH && layer >= 1) convert_layer_weights(F, layer + 1, gw, NGW);
                } } else if (sub == 2) { if (PHE(3)) {
                    pg8::Gemm g{(const bf16_t*)(ws + WS_YG), (const bf16_t*)(ws + WS_WA + WA_GLU), M_TOK, 512, 512, 512, 0, 0};
                    pg8::StaticOrder S; S.init(M_TOK, 512, F.G, (int)blockIdx.x);
                    EpiGlu E{ws, F.glu_b + li * 512};
                    pg8::gemm_phase<EpiGlu, true>(F.lds, g, S, E, F.tid); }
                } else if (sub == 3) { if (PHE(4)) {
                    pg8::Gemm g{(const bf16_t*)(ws + WS_QM), (const bf16_t*)(ws + WS_WA + WA_WOUT), M_TOK, D_MODEL, EVEN_OUT, EVEN_OUT, 0, 0};
                    pg8::StaticOrder S; S.init(M_TOK, D_MODEL, F.G, (int)blockIdx.x);
                    EpiF32 E{(float*)(ws + WS_Y), D_MODEL};
                    pg8::gemm_phase<EpiF32, true>(F.lds, g, S, E, F.tid); }
                } else if (PHE(5)) {
                    norm_phase(F, (const float*)(ws + WS_Y), layer == 0 ? F.x : F.out, F.post_norm + layer * D_MODEL, layer + 1 < DEPTH ? F.pre_norm + (layer + 1) * D_MODEL : nullptr, (bf16_t*)(ws + WS_H));
                }
            } else {
                if (sub == 0) { if (PHE(6)) {
                    pg8::Gemm g{(const bf16_t*)(ws + WS_H), (const bf16_t*)(ws + WS_WB + WB_WIN), M_TOK, ODD_IN, D_MODEL, D_MODEL, 0, 0};
                    pg8::StaticOrder S; S.init(M_TOK, ODD_IN, F.G, (int)blockIdx.x);
                    EpiOddIn E{ws};
                    pg8::gemm_phase<EpiOddIn, true>(F.lds, g, S, E, F.tid); }
                } else if (sub == 1) { if (PHE(7)) {
                    pool_phase(F);
                    if (layer + 1 < DEPTH) convert_layer_weights(F, layer + 1, gw, NGW);
                } } else if (sub == 2) { if (PHE(8)) {
                    pg8::Gemm g{(const bf16_t*)(ws + WS_MIX), (const bf16_t*)(ws + WS_WB + WB_POOL), M_TOK, POOL_W, 512, POOL_W, 2, 512};
                    pg8::StaticOrder S; S.init(M_TOK, POOL_W, F.G, (int)blockIdx.x);
                    EpiPool E{ws, F.pool_scale + li * POOL_W};
                    pg8::gemm_phase<EpiPool, true>(F.lds, g, S, E, F.tid); }
                } else if (sub == 3) { if (PHE(9)) {
                    pg8::Gemm g{(const bf16_t*)(ws + WS_SG), (const bf16_t*)(ws + WS_WB + WB_WOUT), M_TOK, D_MODEL, POOL_W, POOL_W, 0, 0};
                    pg8::StaticOrder S; S.init(M_TOK, D_MODEL, F.G, (int)blockIdx.x);
                    EpiF32 E{(float*)(ws + WS_YO), D_MODEL};
                    pg8::gemm_phase<EpiF32, true>(F.lds, g, S, E, F.tid); }
                } else if (PHE(10)) {
                    norm_phase(F, (const float*)(ws + WS_YO), F.out, F.post_norm + layer * D_MODEL, layer + 1 < DEPTH ? F.pre_norm + (layer + 1) * D_MODEL : nullptr, (bf16_t*)(ws + WS_H));
                }
            }
        }
        if (ph + 1 < hi) GRID_BAR();
    }
}

extern "C" void kernel_launch(void* const* d_in, const int* in_sizes, int n_in, void* d_out, int out_size, void* d_ws, size_t ws_size, hipStream_t stream) {
    static int grid = 0;
    if (grid == 0) {
        if (n_in != 19 || out_size != M_TOK * D_MODEL || ws_size < WS_END) { fprintf(stderr, "kernel_launch: unexpected problem (n_in %d out %d ws %zu)\n", n_in, out_size, ws_size); grid = -1; return; }
        int dev = 0, cus = 0;
        if (hipGetDevice(&dev) != hipSuccess || hipDeviceGetAttribute(&cus, hipDeviceAttributeMultiprocessorCount, dev) != hipSuccess) { grid = -1; return; }
        if (hipFuncSetAttribute((const void*)hybrid_fwd, hipFuncAttributeMaxDynamicSharedMemorySize, LDS_BYTES) != hipSuccess) { fprintf(stderr, "kernel_launch: hipFuncSetAttribute failed\n"); grid = -1; return; }
        int per_cu = 0;
        if (hipOccupancyMaxActiveBlocksPerMultiprocessor(&per_cu, (const void*)hybrid_fwd, 512, LDS_BYTES) != hipSuccess || per_cu < 1) fprintf(stderr, "kernel_launch: occupancy query says %d\n", per_cu);
        (void)hipGetLastError();
        grid = cus;
    }
    if (grid < 0) return;
    (void)hipMemsetAsync((char*)d_ws + WS_CTL, 0, CTL_ZERO_BYTES, stream);
    Args a{};
    for (int i = 0; i < 19; ++i) a.in[i] = (const float*)d_in[i];
    a.out = (float*)d_out; a.ws = (unsigned char*)d_ws;
#if MK_ONE_LAUNCH
    a.ph_lo = 0; a.ph_hi = N_PHASES;
    hipLaunchKernelGGL(hybrid_fwd, dim3(grid), dim3(512), LDS_BYTES, stream, a);
#else
    for (int ph = 0; ph < N_PHASES; ++ph) { a.ph_lo = ph; a.ph_hi = ph + 1; hipLaunchKernelGGL(hybrid_fwd, dim3(grid), dim3(512), LDS_BYTES, stream, a); }
#endif
}
```
